# Optimizing an MI355X kernel written in HIP

```python
import jax, jax.numpy as jnp
from jax import lax
import numpy as np

D_MODEL = 1024
BATCH = 2
SEQ = 8192
DEPTH = 1

HG_HEADS = 4
HG_KEY = 128
HG_VAL = 128
HG_KW = HG_HEADS * HG_KEY
HG_VW = HG_HEADS * HG_VAL
DN_HEADS = 4
DN_KEY = 128
DN_VAL = 128
DN_KW = DN_HEADS * DN_KEY
DN_VW = DN_HEADS * DN_VAL
CONV_W = 4
CHUNK = 64
D_FF = 4 * D_MODEL
ALPHA = (2 * DEPTH) ** 0.25
BETA_INIT = (8 * DEPTH) ** -0.25
LN_EPS = 1e-5
RMS_EPS = 1e-6
L2_EPS = 1e-6
PROJ_SIZES = (HG_KW, HG_KW, HG_VW, HG_VW, 2 * DN_KW + DN_VW, DN_VW, DN_HEADS, DN_HEADS, D_MODEL, D_MODEL)
PROJ_WIDTH = sum(PROJ_SIZES)

kernel_name = "hybrid_hgrn2_gated_deltanet_deepnorm"


def layer_norm(x, g, b):
    xf = x.astype(jnp.float32)
    mu = jnp.mean(xf, -1, keepdims=True)
    var = jnp.mean(jnp.square(xf - mu), -1, keepdims=True)
    return ((xf - mu) * lax.rsqrt(var + LN_EPS) * g.astype(jnp.float32) + b.astype(jnp.float32)).astype(x.dtype)


def gated_rms_norm(o, gate, w):
    of = o.astype(jnp.float32)
    of = of * lax.rsqrt(jnp.mean(of * of, -1, keepdims=True) + RMS_EPS) * w.astype(jnp.float32)
    return (of * jax.nn.silu(gate.astype(jnp.float32))).astype(gate.dtype)


def l2_normalize(x):
    xf = x.astype(jnp.float32)
    return (xf * lax.rsqrt(jnp.sum(xf * xf, -1, keepdims=True) + L2_EPS)).astype(x.dtype)


def causal_depthwise_conv(x, w):
    return lax.conv_general_dilated(x, w[:, None, :].astype(x.dtype), window_strides=(1,),
                                    padding=[(CONV_W - 1, 0)],
                                    dimension_numbers=('NWC', 'WIO', 'NWC'),
                                    feature_group_count=x.shape[-1])


def to_chunks(x, heads):
    B, T, W = x.shape
    return x.reshape(B, T // CHUNK, CHUNK, heads, W // heads).transpose(0, 3, 1, 2, 4)


def to_chunks_scalar(x):
    B, T, H = x.shape
    return x.reshape(B, T // CHUNK, CHUNK, H).transpose(0, 3, 1, 2)


def from_chunks(o):
    B, H, N, C, d = o.shape
    return o.transpose(0, 2, 3, 1, 4).reshape(B, N * C, H, d)


def hgrn2_chunked(q, k, v, log_f):
    b = jnp.cumsum(log_f, axis=3)
    causal = jnp.tril(jnp.ones((CHUNK, CHUNK), dtype=bool))

    def step(S, inp):
        qc, kc, vc, bc = inp
        o_inter = jnp.einsum('bhtk,bhkv->bhtv', qc * jnp.exp(bc), S)
        diff = bc[:, :, :, None, :] - bc[:, :, None, :, :]
        decay = jnp.exp(jnp.where(causal[:, :, None], diff, -jnp.inf))
        scores = jnp.einsum('bhtsk,bhsk->bhts', qc[:, :, :, None, :] * decay, kc)
        o_intra = jnp.einsum('bhts,bhsv->bhtv', scores, vc)
        b_last = bc[:, :, -1:, :]
        S_new = jnp.exp(b_last[:, :, 0, :])[..., None] * S + jnp.einsum(
            'bhsk,bhsv->bhkv', kc * jnp.exp(b_last - bc), vc)
        return S_new.astype(S.dtype), o_inter + o_intra

    xs = tuple(jnp.moveaxis(a, 2, 0) for a in (q, k, v, b))
    S0 = jnp.zeros(q.shape[:2] + (q.shape[-1], v.shape[-1]), dtype=v.dtype)
    _, o = lax.scan(step, S0, xs)
    return jnp.moveaxis(o, 0, 2)


def gated_delta_chunked(q, k, v, g, beta):
    dv = v.shape[-1]
    gc = jnp.cumsum(g, axis=-1)
    causal = jnp.tril(jnp.ones((CHUNK, CHUNK), dtype=bool))
    strict = jnp.tril(jnp.ones((CHUNK, CHUNK), dtype=bool), k=-1)
    decay = jnp.exp(jnp.where(causal, gc[..., :, None] - gc[..., None, :], -jnp.inf))
    k_beta = k * beta[..., None]
    L = jnp.where(strict, jnp.einsum('bhntk,bhnsk->bhnts', k_beta, k) * decay, 0.0)
    eye = jnp.eye(CHUNK, dtype=jnp.float32)
    rhs = jnp.concatenate([v * beta[..., None], k_beta * jnp.exp(gc)[..., None]], axis=-1)
    sol = lax.linalg.triangular_solve((L + eye).astype(jnp.float32), rhs.astype(jnp.float32),
                                      left_side=True, lower=True, unit_diagonal=True).astype(v.dtype)
    u, w = sol[..., :dv], sol[..., dv:]
    qk = jnp.einsum('bhntk,bhnsk->bhnts', q, k) * decay

    def step(S, inp):
        qc, kc, uc, wc, qkc, gcc = inp
        v_new = uc - jnp.einsum('bhck,bhkv->bhcv', wc, S)
        o = jnp.einsum('bhck,bhkv->bhcv', qc * jnp.exp(gcc)[..., None], S) + \
            jnp.einsum('bhts,bhsv->bhtv', qkc, v_new)
        g_last = gcc[..., -1]
        S_new = S * jnp.exp(g_last)[..., None, None] + jnp.einsum(
            'bhsk,bhsv->bhkv', kc * jnp.exp(g_last[..., None] - gcc)[..., None], v_new)
        return S_new.astype(S.dtype), o

    xs = tuple(jnp.moveaxis(a, 2, 0) for a in (q, k, u, w, qk, gc))
    S0 = jnp.zeros(q.shape[:2] + (q.shape[-1], dv), dtype=v.dtype)
    _, o = lax.scan(step, S0, xs)
    return jnp.moveaxis(o, 0, 2)


def token_mixer(h, lb, w_in, conv_w, hg_norm_w, dn_A_log, dn_dt_bias, dn_norm_w, w_branch_a, w_branch_b, w_o):
    B, T, _ = h.shape
    proj = h @ w_in
    split_idx = np.cumsum(PROJ_SIZES)[:-1].tolist()
    hg_q, hg_f, hg_i, hg_g, dn_qkv, dn_z, dn_b, dn_a, gate_a, gate_b = jnp.split(proj, split_idx, axis=-1)

    f = lb + (1.0 - lb) * jax.nn.sigmoid(hg_f.astype(jnp.float32))
    log_f = jnp.log(f)
    k_hg = (1.0 - f).astype(h.dtype)
    q_hg = jax.nn.silu(hg_q) * (HG_KEY ** -0.5)
    o_a = hgrn2_chunked(to_chunks(q_hg, HG_HEADS), to_chunks(k_hg, HG_HEADS),
                        to_chunks(hg_i, HG_HEADS), to_chunks(log_f, HG_HEADS))
    o_a = from_chunks(o_a)
    o_a = gated_rms_norm(o_a, hg_g.reshape(B, T, HG_HEADS, HG_VAL),
                         hg_norm_w.reshape(HG_HEADS, HG_VAL)).reshape(B, T, HG_VW)

    qkv = jax.nn.silu(causal_depthwise_conv(dn_qkv, conv_w))
    dq, dk, dvv = jnp.split(qkv, [DN_KW, 2 * DN_KW], axis=-1)
    dq = l2_normalize(dq.reshape(B, T, DN_HEADS, DN_KEY)).reshape(B, T, DN_KW) * (DN_KEY ** -0.5)
    dk = l2_normalize(dk.reshape(B, T, DN_HEADS, DN_KEY)).reshape(B, T, DN_KW)
    beta = jax.nn.sigmoid(dn_b)
    g = -jnp.exp(dn_A_log.astype(jnp.float32)) * jax.nn.softplus(dn_a.astype(jnp.float32) + dn_dt_bias.astype(jnp.float32))
    o_b = gated_delta_chunked(to_chunks(dq, DN_HEADS), to_chunks(dk, DN_HEADS), to_chunks(dvv, DN_HEADS),
                              to_chunks_scalar(g), to_chunks_scalar(beta))
    o_b = from_chunks(o_b)
    o_b = gated_rms_norm(o_b, dn_z.reshape(B, T, DN_HEADS, DN_VAL), dn_norm_w).reshape(B, T, DN_VW)

    merged = jax.nn.sigmoid(gate_a) * (o_a @ w_branch_a) + jax.nn.sigmoid(gate_b) * (o_b @ w_branch_b)
    return merged @ w_o


def setup_inputs(seed: int = 0) -> dict:
    key = jax.random.key(seed)
    ks = jax.random.split(key, 20)
    f32 = jnp.float32
    x = jax.random.normal(ks[0], (BATCH, SEQ, D_MODEL), f32)
    w_in = jax.random.normal(ks[1], (DEPTH, D_MODEL, PROJ_WIDTH), f32) * D_MODEL ** -0.5
    conv_w = jax.random.normal(ks[2], (DEPTH, CONV_W, 2 * DN_KW + DN_VW), f32) * CONV_W ** -0.5
    hg_lb_logits = jax.random.normal(ks[3], (DEPTH + 1, HG_KW), f32) * 0.1
    hg_norm_w = 1.0 + 0.02 * jax.random.normal(ks[4], (DEPTH, HG_VW), f32)
    dn_A_log = jnp.log(jax.random.uniform(ks[5], (DEPTH, DN_HEADS), f32, 1.0, 16.0))
    dt = jnp.exp(jax.random.uniform(ks[6], (DEPTH, DN_HEADS), f32, np.log(1e-3), np.log(1e-1)))
    dn_dt_bias = dt + jnp.log(-jnp.expm1(-dt))
    dn_norm_w = 1.0 + 0.02 * jax.random.normal(ks[7], (DEPTH, DN_VAL), f32)
    w_branch_a = jax.random.normal(ks[8], (DEPTH, HG_VW, D_MODEL), f32) * HG_VW ** -0.5
    w_branch_b = jax.random.normal(ks[9], (DEPTH, DN_VW, D_MODEL), f32) * DN_VW ** -0.5
    w_o = jax.random.normal(ks[10], (DEPTH, D_MODEL, D_MODEL), f32) * (2.0 / (2 * D_MODEL)) ** 0.5 * BETA_INIT
    ln1_g = 1.0 + 0.02 * jax.random.normal(ks[11], (DEPTH, D_MODEL), f32)
    ln1_b = 0.02 * jax.random.normal(ks[12], (DEPTH, D_MODEL), f32)
    w_up = jax.random.normal(ks[13], (DEPTH, D_MODEL, D_FF), f32) * (2.0 / (D_MODEL + D_FF)) ** 0.5
    w_down = jax.random.normal(ks[14], (DEPTH, D_FF, D_MODEL), f32) * (2.0 / (D_MODEL + D_FF)) ** 0.5 * BETA_INIT
    ln2_g = 1.0 + 0.02 * jax.random.normal(ks[15], (DEPTH, D_MODEL), f32)
    ln2_b = 0.02 * jax.random.normal(ks[16], (DEPTH, D_MODEL), f32)
    return {"x": x, "hg_lb_logits": hg_lb_logits, "w_in": w_in, "conv_w": conv_w, "hg_norm_w": hg_norm_w,
            "dn_A_log": dn_A_log, "dn_dt_bias": dn_dt_bias, "dn_norm_w": dn_norm_w,
            "w_branch_a": w_branch_a, "w_branch_b": w_branch_b, "w_o": w_o,
            "ln1_g": ln1_g, "ln1_b": ln1_b, "w_up": w_up, "w_down": w_down, "ln2_g": ln2_g, "ln2_b": ln2_b}


def reference(x, hg_lb_logits, w_in, conv_w, hg_norm_w, dn_A_log, dn_dt_bias, dn_norm_w,
              w_branch_a, w_branch_b, w_o, ln1_g, ln1_b, w_up, w_down, ln2_g, ln2_b):
    lower_bounds = jnp.cumsum(jax.nn.softmax(hg_lb_logits.astype(jnp.float32), axis=0), axis=0)
    h = x
    for l in range(DEPTH):
        mix = token_mixer(h, lower_bounds[l], w_in[l], conv_w[l], hg_norm_w[l], dn_A_log[l], dn_dt_bias[l],
                          dn_norm_w[l], w_branch_a[l], w_branch_b[l], w_o[l])
        h = layer_norm(ALPHA * h + mix, ln1_g[l], ln1_b[l])
        mlp = jnp.square(jax.nn.relu(h @ w_up[l])) @ w_down[l]
        h = layer_norm(ALPHA * h + mlp, ln2_g[l], ln2_b[l])
    return h
```

```cpp
#include <hip/hip_runtime.h>
#include <cstdint>
#include <cstdio>

typedef unsigned short bf16_t;
__device__ __forceinline__ float bf2f(bf16_t v) { return __uint_as_float((unsigned)v << 16); }
__device__ __forceinline__ bf16_t f2bf(float f) { unsigned u = __float_as_uint(f); return (bf16_t)((u + 0x7fffu + ((u >> 16) & 1u)) >> 16); }

constexpr int M = 16384, D = 1024, T = 8192, NH = 4, DK = 128, FF = 4096, PROJW = 6152, NCH = 128;
constexpr float ALPHA = 1.189207115002721f;
constexpr float LN_EPS = 1e-5f, RMS_EPS = 1e-6f, L2_EPS = 1e-6f;
constexpr float QSCALE = 0.08838834764831845f;

constexpr size_t MiB = 1u << 20;
constexpr size_t WS_CTL = 0;
constexpr size_t WS_GBT = 1 * MiB;
constexpr size_t WS_DEC = 1 * MiB + 512 * 1024;
constexpr size_t WS_HALO = 2 * MiB + 512 * 1024;
constexpr size_t WS_WIN = 5 * MiB, WS_WBAB = 17 * MiB, WS_WO = 19 * MiB, WS_WUP = 21 * MiB, WS_WDN = 29 * MiB;
constexpr size_t WS_XB = 37 * MiB;
constexpr size_t WS_HGR = 69 * MiB;
constexpr size_t WS_DNR = 133 * MiB;
constexpr size_t WS_HB = 69 * MiB;
constexpr size_t WS_OLH = 197 * MiB, WS_OLD = 213 * MiB;
constexpr size_t WS_MRG = 197 * MiB;
constexpr size_t WS_END = 256 * MiB;

__host__ __device__ __forceinline__ int orig_col(int n) {
    if (n >= 4096) return n + 8;
    const int grp = n >> 11, h = (n >> 9) & 3, part = (n >> 7) & 3, c = n & 127;
    if (grp == 0) return part * 512 + h * 128 + c;
    return (part < 3 ? 2048 + part * 512 : 3584) + h * 128 + c;
}

__device__ __forceinline__ float sigmoidf_(float x) { return 1.f / (1.f + __expf(-x)); }
__device__ __forceinline__ float siluf_(float x) { return x / (1.f + __expf(-x)); }

__device__ __forceinline__ float ldA(const float* p) { return *p; }
__device__ __forceinline__ float ldA(const bf16_t* p) { return bf2f(*p); }

template <typename AT, class ColMap, class Epi>
__global__ void __launch_bounds__(256) ngemm(const AT* A, int lda, const float* B, int ldb, int K, Epi epi) {
    const ColMap cm{};
    __shared__ float As[16][68];
    __shared__ float Bs[16][68];
    const int tid = threadIdx.x, tx = tid & 15, ty = tid >> 4;
    const int m0 = blockIdx.y * 64, n0 = blockIdx.x * 64;
    float acc[4][4];
#pragma unroll
    for (int i = 0; i < 4; ++i)
#pragma unroll
        for (int j = 0; j < 4; ++j) acc[i][j] = 0.f;
    int bcol[4];
#pragma unroll
    for (int j = 0; j < 4; ++j) bcol[j] = cm(n0 + (tid & 15) * 4 + j);
    for (int k0 = 0; k0 < K; k0 += 16) {
        {
            const int r = tid >> 2, kk = (tid & 3) * 4;
            const AT* ap = A + (size_t)(m0 + r) * lda + k0 + kk;
#pragma unroll
            for (int j = 0; j < 4; ++j) As[kk + j][r] = ldA(ap + j);
        }
        {
            const int kk = tid >> 4;
            const float* bp = B + (size_t)(k0 + kk) * ldb;
#pragma unroll
            for (int j = 0; j < 4; ++j) Bs[kk][(tid & 15) * 4 + j] = bp[bcol[j]];
        }
        __syncthreads();
#pragma unroll
        for (int kk = 0; kk < 16; ++kk) {
            float a[4], b[4];
#pragma unroll
            for (int i = 0; i < 4; ++i) a[i] = As[kk][ty * 4 + i];
#pragma unroll
            for (int j = 0; j < 4; ++j) b[j] = Bs[kk][tx * 4 + j];
#pragma unroll
            for (int i = 0; i < 4; ++i)
#pragma unroll
                for (int j = 0; j < 4; ++j) acc[i][j] += a[i] * b[j];
        }
        __syncthreads();
    }
#pragma unroll
    for (int i = 0; i < 4; ++i)
#pragma unroll
        for (int j = 0; j < 4; ++j) epi(m0 + ty * 4 + i, n0 + tx * 4 + j, acc[i][j]);
}

struct IdMap { __device__ __forceinline__ int operator()(int n) const { return n; } };
struct InMap { __device__ __forceinline__ int operator()(int n) const { return orig_col(n); } };

struct EpiInProj {
    bf16_t* hgr; bf16_t* dnr; bf16_t* halo; bf16_t* gab; const float* lbl;
    __device__ __forceinline__ void operator()(int m, int n, float v) const {
        if (n >= 4096) { gab[(size_t)m * 2048 + (n - 4096)] = f2bf(sigmoidf_(v)); return; }
        const int grp = n >> 11, h = (n >> 9) & 3, part = (n >> 7) & 3, c = n & 127;
        const size_t off = ((size_t)((m >> 6) * 4 + h)) * 32768 + part * 8192 + (m & 63) * 128 + c;
        if (grp == 0) {
            float o;
            if (part == 0) o = siluf_(v) * QSCALE;
            else if (part == 1) { const int ch = h * 128 + c; const float lb = sigmoidf_(lbl[ch] - lbl[512 + ch]); const float f = lb + (1.f - lb) * sigmoidf_(v); o = __logf(f); }
            else if (part == 2) o = v;
            else o = siluf_(v);
            hgr[off] = f2bf(o);
        } else {
            const float o = (part == 3) ? siluf_(v) : v;
            dnr[off] = f2bf(o);
            if (part < 3 && (m & 63) >= 61) halo[(size_t)(m >> 6) * 4608 + ((m & 63) - 61) * 1536 + h * 384 + part * 128 + c] = f2bf(o);
        }
    }
};

__global__ void __launch_bounds__(256) k_gbeta(const float* x, const float* w_in, const float* A_log, const float* dt_bias, float* gbt) {
    const int lane = threadIdx.x & 63, wave = (blockIdx.x * 256 + threadIdx.x) >> 6;
    if (wave >= M) return;
    float acc[8];
#pragma unroll
    for (int j = 0; j < 8; ++j) acc[j] = 0.f;
    const float* xr = x + (size_t)wave * D;
    for (int i = 0; i < 16; ++i) {
        const int k = lane + 64 * i; const float xv = xr[k];
        const float* wp = w_in + (size_t)k * PROJW + 4096;
#pragma unroll
        for (int j = 0; j < 8; ++j) acc[j] += xv * wp[j];
    }
#pragma unroll
    for (int j = 0; j < 8; ++j) {
#pragma unroll
        for (int o = 1; o < 64; o <<= 1) acc[j] += __shfl_xor(acc[j], o);
    }
    if (lane < 4) gbt[(size_t)wave * 8 + lane] = sigmoidf_(lane == 0 ? acc[0] : lane == 1 ? acc[1] : lane == 2 ? acc[2] : acc[3]);
    else if (lane < 8) {
        const int h = lane - 4; const float a = (h == 0 ? acc[4] : h == 1 ? acc[5] : h == 2 ? acc[6] : acc[7]) + dt_bias[h];
        const float sp = a > 20.f ? a : log1pf(expf(a));
        gbt[(size_t)wave * 8 + lane] = -expf(A_log[h]) * sp;
    }
}

__global__ void __launch_bounds__(128) k_hg_naive(const bf16_t* hgr, const float* normw, bf16_t* oab) {
    __shared__ float qs[16][128], fs[16][128], vs[16][128], ob[16][128];
    const int bh = blockIdx.x, b = bh >> 2, h = bh & 3, tid = threadIdx.x;
    float S[128];
#pragma unroll
    for (int k = 0; k < 128; ++k) S[k] = 0.f;
    for (int n = 0; n < NCH; ++n) {
        const int rb = b * NCH + n;
        const bf16_t* blk = hgr + (size_t)(rb * 4 + h) * 32768;
        for (int t0 = 0; t0 < 64; t0 += 16) {
            for (int i = tid; i < 16 * 128; i += 128) {
                const int tt = i >> 7, c = i & 127; const int o = (t0 + tt) * 128 + c;
                qs[tt][c] = bf2f(blk[o]); fs[tt][c] = __expf(bf2f(blk[8192 + o])); vs[tt][c] = bf2f(blk[16384 + o]);
            }
            __syncthreads();
            for (int tt = 0; tt < 16; ++tt) {
                const float vv = vs[tt][tid]; float o = 0.f;
#pragma unroll
                for (int k = 0; k < 128; ++k) { const float f = fs[tt][k]; S[k] = f * S[k] + (1.f - f) * vv; o += qs[tt][k] * S[k]; }
                ob[tt][tid] = o;
            }
            __syncthreads();
            {
                const int tt = tid >> 3, sub = tid & 7; float ss = 0.f;
                for (int j = 0; j < 16; ++j) { const float o = ob[tt][sub * 16 + j]; ss += o * o; }
                ss += __shfl_xor(ss, 1); ss += __shfl_xor(ss, 2); ss += __shfl_xor(ss, 4);
                const float rstd = rsqrtf(ss * (1.f / 128.f) + RMS_EPS);
                const int m = rb * 64 + t0 + tt;
                for (int j = 0; j < 16; ++j) { const int v = sub * 16 + j;
                    const float gate = bf2f(blk[24576 + (t0 + tt) * 128 + v]);
                    oab[(size_t)m * 1024 + h * 128 + v] = f2bf(ob[tt][v] * rstd * normw[h * 128 + v] * gate); }
            }
            __syncthreads();
        }
    }
}

__global__ void __launch_bounds__(128) k_dn_naive(const bf16_t* dnr, const bf16_t* halo, const float* convw, const float* gbt, const float* normw, bf16_t* oab) {
    __shared__ float raw[19][384];
    __shared__ float qs[16][128], ks[16][128], vs[16][128], ob[16][128];
    const int bh = blockIdx.x, b = bh >> 2, h = bh & 3, tid = threadIdx.x;
    float S[128];
#pragma unroll
    for (int k = 0; k < 128; ++k) S[k] = 0.f;
    for (int n = 0; n < NCH; ++n) {
        const int rb = b * NCH + n;
        const bf16_t* blk = dnr + (size_t)(rb * 4 + h) * 32768;
        for (int t0 = 0; t0 < 64; t0 += 16) {
            for (int i = tid; i < 19 * 384; i += 128) {
                const int r = i / 384, cc = i % 384, part = cc >> 7, c = cc & 127; const int t = t0 - 3 + r;
                float v;
                if (t >= 0) v = bf2f(blk[part * 8192 + t * 128 + c]);
                else if (n == 0) v = 0.f;
                else v = bf2f(halo[(size_t)(rb - 1) * 4608 + (t + 3) * 1536 + h * 384 + part * 128 + c]);
                raw[r][cc] = v;
            }
            __syncthreads();
            for (int i = tid; i < 16 * 384; i += 128) {
                const int tt = i / 384, cc = i % 384, part = cc >> 7, c = cc & 127; const int ch = part * 512 + h * 128 + c;
                float a = 0.f;
#pragma unroll
                for (int j = 0; j < 4; ++j) a += convw[j * 1536 + ch] * raw[tt + j][cc];
                a = siluf_(a);
                if (part == 0) qs[tt][c] = a; else if (part == 1) ks[tt][c] = a; else vs[tt][c] = a;
            }
            __syncthreads();
            {
                const int tt = tid >> 3, sub = tid & 7; float sq = 0.f, sk = 0.f;
                for (int j = 0; j < 16; ++j) { const float a = qs[tt][sub * 16 + j], bb = ks[tt][sub * 16 + j]; sq += a * a; sk += bb * bb; }
                sq += __shfl_xor(sq, 1); sq += __shfl_xor(sq, 2); sq += __shfl_xor(sq, 4);
                sk += __shfl_xor(sk, 1); sk += __shfl_xor(sk, 2); sk += __shfl_xor(sk, 4);
                const float rq = rsqrtf(sq + L2_EPS) * QSCALE, rk = rsqrtf(sk + L2_EPS);
                for (int j = 0; j < 16; ++j) { qs[tt][sub * 16 + j] *= rq; ks[tt][sub * 16 + j] *= rk; }
            }
            __syncthreads();
            for (int tt = 0; tt < 16; ++tt) {
                const int m = rb * 64 + t0 + tt;
                const float beta = gbt[(size_t)m * 8 + h], eg = __expf(gbt[(size_t)m * 8 + 4 + h]);
                float kS = 0.f;
#pragma unroll
                for (int k = 0; k < 128; ++k) kS += ks[tt][k] * S[k];
                const float vnew = beta * (vs[tt][tid] - eg * kS);
                float o = 0.f;
#pragma unroll
                for (int k = 0; k < 128; ++k) { S[k] = eg * S[k] + ks[tt][k] * vnew; o += qs[tt][k] * S[k]; }
                ob[tt][tid] = o;
            }
            __syncthreads();
            {
                const int tt = tid >> 3, sub = tid & 7; float ss = 0.f;
                for (int j = 0; j < 16; ++j) { const float o = ob[tt][sub * 16 + j]; ss += o * o; }
                ss += __shfl_xor(ss, 1); ss += __shfl_xor(ss, 2); ss += __shfl_xor(ss, 4);
                const float rstd = rsqrtf(ss * (1.f / 128.f) + RMS_EPS);
                const int m = rb * 64 + t0 + tt;
                for (int j = 0; j < 16; ++j) { const int v = sub * 16 + j;
                    const float gate = bf2f(blk[24576 + (t0 + tt) * 128 + v]);
                    oab[(size_t)m * 1024 + 512 + h * 128 + v] = f2bf(ob[tt][v] * rstd * normw[v] * gate); }
            }
            __syncthreads();
        }
    }
}

struct EpiMergeA { const bf16_t* gab; bf16_t* mrg; __device__ __forceinline__ void operator()(int m, int n, float v) const { mrg[(size_t)m * 1024 + n] = f2bf(bf2f(gab[(size_t)m * 2048 + n]) * v); } };
struct EpiMergeB { const bf16_t* gab; bf16_t* mrg; __device__ __forceinline__ void operator()(int m, int n, float v) const { const size_t i = (size_t)m * 1024 + n; mrg[i] = f2bf(bf2f(mrg[i]) + bf2f(gab[(size_t)m * 2048 + 1024 + n]) * v); } };
struct EpiResX { const float* base; float* out; __device__ __forceinline__ void operator()(int m, int n, float v) const { const size_t i = (size_t)m * 1024 + n; out[i] = ALPHA * base[i] + v; } };
struct EpiRelu2 { bf16_t* hb; __device__ __forceinline__ void operator()(int m, int n, float v) const { const float r = v > 0.f ? v : 0.f; hb[(size_t)m * FF + n] = f2bf(r * r); } };

__global__ void __launch_bounds__(256) k_ln(float* io, const float* g, const float* bta, bf16_t* copy) {
    const int lane = threadIdx.x & 63, row = (blockIdx.x * 256 + threadIdx.x) >> 6;
    if (row >= M) return;
    float v[16]; float s = 0.f;
    float* r = io + (size_t)row * D;
#pragma unroll
    for (int i = 0; i < 16; ++i) { v[i] = r[lane + 64 * i]; s += v[i]; }
#pragma unroll
    for (int o = 1; o < 64; o <<= 1) s += __shfl_xor(s, o);
    const float mean = s * (1.f / D); float q = 0.f;
#pragma unroll
    for (int i = 0; i < 16; ++i) { v[i] -= mean; q += v[i] * v[i]; }
#pragma unroll
    for (int o = 1; o < 64; o <<= 1) q += __shfl_xor(q, o);
    const float rstd = rsqrtf(q * (1.f / D) + LN_EPS);
#pragma unroll
    for (int i = 0; i < 16; ++i) { const int c = lane + 64 * i; const float o = v[i] * rstd * g[c] + bta[c]; r[c] = o; if (copy) copy[(size_t)row * D + c] = f2bf(o); }
}

extern "C" void kernel_launch(void* const* d_in, const int* in_sizes, int n_in, void* d_out, int out_size, void* d_ws, size_t ws_size, hipStream_t stream) {
    if (n_in != 17 || ws_size < WS_END || out_size != M * D) { fprintf(stderr, "kernel_launch: unexpected shapes n_in=%d ws=%zu out=%d\n", n_in, ws_size, out_size); return; }
    const float* x = (const float*)d_in[0]; const float* lbl = (const float*)d_in[1]; const float* w_in = (const float*)d_in[2];
    const float* convw = (const float*)d_in[3]; const float* hg_nw = (const float*)d_in[4]; const float* A_log = (const float*)d_in[5];
    const float* dt_bias = (const float*)d_in[6]; const float* dn_nw = (const float*)d_in[7]; const float* wba = (const float*)d_in[8];
    const float* wbb = (const float*)d_in[9]; const float* wo = (const float*)d_in[10]; const float* ln1g = (const float*)d_in[11];
    const float* ln1b = (const float*)d_in[12]; const float* wup = (const float*)d_in[13]; const float* wdn = (const float*)d_in[14];
    const float* ln2g = (const float*)d_in[15]; const float* ln2b = (const float*)d_in[16];
    unsigned char* ws = (unsigned char*)d_ws; float* out = (float*)d_out;
    float* gbt = (float*)(ws + WS_GBT); bf16_t* halo = (bf16_t*)(ws + WS_HALO);
    bf16_t* hgr = (bf16_t*)(ws + WS_HGR); bf16_t* dnr = (bf16_t*)(ws + WS_DNR); bf16_t* gab = (bf16_t*)d_out;
    bf16_t* oab = (bf16_t*)(ws + WS_XB); bf16_t* mrg = (bf16_t*)(ws + WS_MRG); bf16_t* h1b = (bf16_t*)(ws + WS_XB); bf16_t* hb = (bf16_t*)(ws + WS_HB);

    k_gbeta<<<M / 4, 256, 0, stream>>>(x, w_in, A_log, dt_bias, gbt);
    ngemm<float, InMap, EpiInProj><<<dim3(6144 / 64, M / 64), 256, 0, stream>>>(x, D, w_in, PROJW, D, EpiInProj{hgr, dnr, halo, gab, lbl});
    k_hg_naive<<<8, 128, 0, stream>>>(hgr, hg_nw, oab);
    k_dn_naive<<<8, 128, 0, stream>>>(dnr, halo, convw, gbt, dn_nw, oab);
    ngemm<bf16_t, IdMap, EpiMergeA><<<dim3(1024 / 64, M / 64), 256, 0, stream>>>(oab, 1024, wba, 1024, 512, EpiMergeA{gab, mrg});
    ngemm<bf16_t, IdMap, EpiMergeB><<<dim3(1024 / 64, M / 64), 256, 0, stream>>>(oab + 512, 1024, wbb, 1024, 512, EpiMergeB{gab, mrg});
    ngemm<bf16_t, IdMap, EpiResX><<<dim3(1024 / 64, M / 64), 256, 0, stream>>>(mrg, 1024, wo, 1024, 1024, EpiResX{x, out});
    k_ln<<<M / 4, 256, 0, stream>>>(out, ln1g, ln1b, h1b);
    ngemm<bf16_t, IdMap, EpiRelu2><<<dim3(FF / 64, M / 64), 256, 0, stream>>>(h1b, 1024, wup, FF, 1024, EpiRelu2{hb});
    ngemm<bf16_t, IdMap, EpiResX><<<dim3(1024 / 64, M / 64), 256, 0, stream>>>(hb, FF, wdn, 1024, FF, EpiResX{out, out});
    k_ln<<<M / 4, 256, 0, stream>>>(out, ln2g, ln2b, nullptr);
}
```
